# Optimizing an MI355X kernel written in HIP

```python
import jax, jax.numpy as jnp
from jax import lax
import numpy as np

D_MODEL = 2048
BATCH = 1
SEQ = 8192
DEPTH = 1

CTX_LEN = 256
GRID_W = 64
D_MIX = D_MODEL
W_CONV = D_MIX // 2
W_LRU = D_MIX - W_CONV
N_CONV_GROUPS = 16
N_LRU_HEADS = 16
LRU_HEAD_DIM = W_LRU // N_LRU_HEADS
CONV_A_WIDTH = 3
CONV_A_LEFT = 1
CONV_B_WIDTH = 4
CONV_B_LEFT = 2
LRU_C = 8.0
N_DIR = 2
D_IN_PROJ = 4 * W_CONV + 2 * W_LRU
EPS = 1e-6

kernel_name = "hybrid_conv_rglru_parallel_heads_dit"


def _rmsnorm(x, g):
    xf = x.astype(jnp.float32)
    y = xf * lax.rsqrt(jnp.mean(xf * xf, axis=-1, keepdims=True) + EPS)
    return (y * g.astype(jnp.float32)).astype(x.dtype)


def _dwconv(x, w, axis, left):
    k = w.shape[0]
    n = x.shape[axis]
    pad = [(0, 0)] * x.ndim
    pad[axis] = (left, k - 1 - left)
    xp = jnp.pad(x, pad)
    out = lax.slice_in_dim(xp, 0, n, axis=axis) * w[0]
    for j in range(1, k):
        out = out + lax.slice_in_dim(xp, j, j + n, axis=axis) * w[j]
    return out


def _conv_latent(x, w, left):
    b, l, ch = x.shape
    rows = l // GRID_W
    return _dwconv(x.reshape(b, rows, GRID_W, ch), w, 2, left).reshape(b, l, ch)


def _conv_context(x, w, left):
    return _dwconv(x, w, 1, left)


def _blockdiag(x, w, b):
    bsz, l, _ = x.shape
    y = jnp.einsum('blhi,hij->blhj', x.reshape(bsz, l, N_LRU_HEADS, LRU_HEAD_DIM), w)
    return y.reshape(bsz, l, W_LRU) + b


def _lru_coeffs(xb, wa, ba, wx, bx, lam):
    xf = xb.astype(jnp.float32)
    r = jax.nn.sigmoid(_blockdiag(xf, wa.astype(jnp.float32), ba.astype(jnp.float32)))
    i = jax.nn.sigmoid(_blockdiag(xf, wx.astype(jnp.float32), bx.astype(jnp.float32)))
    log_a = -LRU_C * r * jax.nn.softplus(-lam.astype(jnp.float32))
    a = jnp.exp(log_a)
    bterm = jnp.sqrt(-jnp.expm1(2.0 * log_a)) * (i * xf)
    return a, bterm


def _combine(e1, e2):
    a1, b1 = e1
    a2, b2 = e2
    return a1 * a2, a2 * b1 + b2


def _linear_scan(a, b, h0, reverse):
    if h0 is not None:
        idx = -1 if reverse else 0
        b = b.at[:, idx].add(a[:, idx] * h0)
    _, h = lax.associative_scan(_combine, (a, b), reverse=reverse, axis=1)
    return h


def _split_proj(p):
    cuts = [W_CONV, 2 * W_CONV, 3 * W_CONV, 4 * W_CONV, 4 * W_CONV + W_LRU]
    return jnp.split(p, cuts, axis=-1)


def setup_inputs(seed: int = 0) -> dict:
    key = jax.random.key(seed)
    ks = jax.random.split(key, 20)
    f = jnp.float32
    nrm = lambda k, s, sc: jax.random.normal(k, s, f) * sc
    a0 = jax.random.uniform(ks[17], (DEPTH, N_DIR, W_LRU), f, 0.9, 0.999)
    s = a0 ** (1.0 / LRU_C)
    lru_lambda = jnp.log(s) - jnp.log1p(-s)
    return {
        "x": nrm(ks[0], (BATCH, SEQ, D_MODEL), 1.0),
        "c": nrm(ks[1], (BATCH, D_MODEL), 1.0),
        "ctx": nrm(ks[2], (BATCH, CTX_LEN, D_MODEL), 1.0),
        "c_ctx": nrm(ks[3], (D_MODEL,), 1.0),
        "norm_g": 1.0 + nrm(ks[4], (DEPTH, D_MODEL), 0.02),
        "w_ada": nrm(ks[5], (DEPTH, D_MODEL, 3 * D_MODEL), 0.5 * D_MODEL ** -0.5),
        "b_ada": nrm(ks[6], (DEPTH, 3 * D_MODEL), 0.02),
        "w_in": nrm(ks[7], (DEPTH, D_MODEL, D_IN_PROJ), D_MODEL ** -0.5),
        "w_conv_a": nrm(ks[8], (DEPTH, CONV_A_WIDTH, W_CONV), CONV_A_WIDTH ** -0.5),
        "w_conv_b": nrm(ks[9], (DEPTH, CONV_B_WIDTH, W_LRU), CONV_B_WIDTH ** -0.5),
        "b_conv_b": nrm(ks[10], (DEPTH, W_LRU), 0.02),
        "lru_wa": nrm(ks[11], (DEPTH, N_DIR, N_LRU_HEADS, LRU_HEAD_DIM, LRU_HEAD_DIM), LRU_HEAD_DIM ** -0.5),
        "lru_ba": nrm(ks[12], (DEPTH, N_DIR, W_LRU), 0.02),
        "lru_wx": nrm(ks[13], (DEPTH, N_DIR, N_LRU_HEADS, LRU_HEAD_DIM, LRU_HEAD_DIM), LRU_HEAD_DIM ** -0.5),
        "lru_bx": nrm(ks[14], (DEPTH, N_DIR, W_LRU), 0.02),
        "lru_lambda": lru_lambda,
        "w_out": nrm(ks[15], (DEPTH, D_MIX, D_MODEL), D_MIX ** -0.5),
        "final_g": 1.0 + nrm(ks[16], (D_MODEL,), 0.02),
    }


def reference(x, c, ctx, c_ctx, norm_g, w_ada, b_ada, w_in, w_conv_a, w_conv_b, b_conv_b,
              lru_wa, lru_ba, lru_wx, lru_bx, lru_lambda, w_out, final_g):
    h_lat = x
    h_ctx = ctx
    for l in range(DEPTH):
        last = l == DEPTH - 1
        mod_lat = jax.nn.silu(c) @ w_ada[l] + b_ada[l]
        sh_l, sc_l, gt_l = jnp.split(mod_lat, 3, axis=-1)
        mod_ctx = jax.nn.silu(c_ctx) @ w_ada[l] + b_ada[l]
        sh_c, sc_c, gt_c = jnp.split(mod_ctx, 3, axis=-1)

        hl = _rmsnorm(h_lat, norm_g[l]) * (1.0 + sc_l[:, None]) + sh_l[:, None]
        hc = _rmsnorm(h_ctx, norm_g[l]) * (1.0 + sc_c) + sh_c

        bl, cl, ul, gl, vl, ql = _split_proj(hl @ w_in[l])
        bc, cc_, uc, gc, vc, qc = _split_proj(hc @ w_in[l])

        ya = bl * _conv_latent(cl * ul, w_conv_a[l], CONV_A_LEFT) * jax.nn.silu(gl)

        xbl = _conv_latent(vl, w_conv_b[l], CONV_B_LEFT) + b_conv_b[l]
        xbc = _conv_context(vc, w_conv_b[l], CONV_B_LEFT) + b_conv_b[l]
        y_lru = None
        ctx_states = []
        for d, rev in enumerate((False, True)):
            a_c, b_c = _lru_coeffs(xbc, lru_wa[l, d], lru_ba[l, d], lru_wx[l, d], lru_bx[l, d], lru_lambda[l, d])
            hs_c = _linear_scan(a_c, b_c, None, rev)
            h0 = hs_c[:, 0] if rev else hs_c[:, -1]
            a_l, b_l = _lru_coeffs(xbl, lru_wa[l, d], lru_ba[l, d], lru_wx[l, d], lru_bx[l, d], lru_lambda[l, d])
            hs_l = _linear_scan(a_l, b_l, h0, rev)
            y_lru = hs_l if y_lru is None else y_lru + hs_l
            ctx_states.append(hs_c)
        yb = y_lru.astype(h_lat.dtype) * jax.nn.silu(ql)

        out_lat = jnp.concatenate([ya, yb], axis=-1) @ w_out[l]
        new_lat = h_lat + gt_l[:, None] * out_lat

        if not last:
            ya_c = bc * _conv_context(cc_ * uc, w_conv_a[l], CONV_A_LEFT) * jax.nn.silu(gc)
            yb_c = (ctx_states[0] + ctx_states[1]).astype(h_ctx.dtype) * jax.nn.silu(qc)
            out_ctx = jnp.concatenate([ya_c, yb_c], axis=-1) @ w_out[l]
            h_ctx = h_ctx + gt_c * out_ctx
        h_lat = new_lat
    return _rmsnorm(h_lat, final_g)
```

```cpp
#include <hip/hip_runtime.h>
#include <cstdint>
#include <cstdio>

constexpr int D = 2048, SEQ = 8192, CTX = 256, GW = 64, WC = 1024, WL = 1024, NH = 16, HD = 64, NPROJ = 6144;
constexpr float EPS = 1e-6f;

__device__ __forceinline__ float sigmoidf_(float x) { return 1.f / (1.f + expf(-x)); }
__device__ __forceinline__ float siluf_(float x) { return x * sigmoidf_(x); }

__global__ void __launch_bounds__(256) k_ada(const float* c, const float* cctx, const float* w, const float* b, float* mod) {
    __shared__ float s0[D], s1[D];
    for (int i = threadIdx.x; i < D; i += 256) { s0[i] = siluf_(c[i]); s1[i] = siluf_(cctx[i]); }
    __syncthreads();
    const int n = blockIdx.x * 256 + threadIdx.x;
    float a0 = 0.f, a1 = 0.f;
    for (int k = 0; k < D; ++k) { const float wv = w[(size_t)k * NPROJ + n]; a0 += s0[k] * wv; a1 += s1[k] * wv; }
    mod[n] = a0 + b[n]; mod[NPROJ + n] = a1 + b[n];
}

__global__ void __launch_bounds__(256) k_normmod(const float* x, const float* g, const float* mod  , float* out) {
    __shared__ float red[256];
    const size_t row = blockIdx.x;
    const float* xr = x + row * D;
    float s = 0.f;
    for (int i = threadIdx.x; i < D; i += 256) { const float v = xr[i]; s += v * v; }
    red[threadIdx.x] = s; __syncthreads();
    for (int o = 128; o > 0; o >>= 1) { if (threadIdx.x < o) red[threadIdx.x] += red[threadIdx.x + o]; __syncthreads(); }
    const float rinv = rsqrtf(red[0] / D + EPS);
    for (int i = threadIdx.x; i < D; i += 256) out[row * D + i] = xr[i] * rinv * g[i] * (1.f + mod[D + i]) + mod[i];
}

template <int MODE>
__global__ void __launch_bounds__(256) k_gemm(const float* A, int lda, const float* B, int ldb, float* C, int ldc, int K, const float* xres, const float* gt) {
    __shared__ float As[16][68], Bs[16][68];
    const int tid = threadIdx.x, tx = tid & 15, ty = tid >> 4;
    const int m0 = blockIdx.y * 64, n0 = blockIdx.x * 64;
    float acc[4][4];
#pragma unroll
    for (int i = 0; i < 4; ++i)
#pragma unroll
        for (int j = 0; j < 4; ++j) acc[i][j] = 0.f;
    for (int k0 = 0; k0 < K; k0 += 16) {
#pragma unroll
        for (int i = 0; i < 4; ++i) {
            const int idx = tid + i * 256;
            { const int m = idx >> 4, k = idx & 15; int kk = k0 + k; if (MODE == 1 && kk >= 1024) kk += 1024; As[k][m] = A[(size_t)(m0 + m) * lda + kk]; }
            { const int k = idx >> 6, n = idx & 63; Bs[k][n] = B[(size_t)(k0 + k) * ldb + n0 + n]; }
        }
        __syncthreads();
#pragma unroll
        for (int k = 0; k < 16; ++k) {
            float a[4], b[4];
#pragma unroll
            for (int i = 0; i < 4; ++i) { a[i] = As[k][ty * 4 + i]; b[i] = Bs[k][tx * 4 + i]; }
#pragma unroll
            for (int i = 0; i < 4; ++i)
#pragma unroll
                for (int j = 0; j < 4; ++j) acc[i][j] += a[i] * b[j];
        }
        __syncthreads();
    }
#pragma unroll
    for (int i = 0; i < 4; ++i)
#pragma unroll
        for (int j = 0; j < 4; ++j) {
            const size_t r = m0 + ty * 4 + i; const int cc = n0 + tx * 4 + j;
            if (MODE == 1) C[r * ldc + cc] = xres[r * D + cc] + gt[cc] * acc[i][j];
            else C[r * ldc + cc] = acc[i][j];
        }
}

__global__ void __launch_bounds__(256) k_mixA(float* P, const float* wca) {
    const size_t idx = (size_t)blockIdx.x * 256 + threadIdx.x;
    const int ch = (int)(idx % WC); const int t = (int)(idx / WC); const int w = t % GW;
    float* row = P + (size_t)t * NPROJ;
    float z0 = 0.f, z2 = 0.f;
    const float z1 = row[WC + ch] * row[2 * WC + ch];
    if (w > 0) z0 = row[-NPROJ + WC + ch] * row[-NPROJ + 2 * WC + ch];
    if (w < GW - 1) z2 = row[NPROJ + WC + ch] * row[NPROJ + 2 * WC + ch];
    const float cv = wca[ch] * z0 + wca[WC + ch] * z1 + wca[2 * WC + ch] * z2;
    row[ch] = row[ch] * cv * siluf_(row[3 * WC + ch]);
}

__global__ void __launch_bounds__(256) k_convB(const float* src, int lds_, float* dst, int ldd, const float* wcb, const float* bcb, int period) {
    const size_t idx = (size_t)blockIdx.x * 256 + threadIdx.x;
    const int ch = (int)(idx % WL); const int t = (int)(idx / WL); const int w = t % period;
    const float* s = src + (size_t)t * lds_ + ch;
    float acc = bcb[ch] + wcb[2 * WL + ch] * s[0];
    if (w >= 2) acc += wcb[ch] * s[-2 * (long)lds_];
    if (w >= 1) acc += wcb[WL + ch] * s[-(long)lds_];
    if (w < period - 1) acc += wcb[3 * WL + ch] * s[lds_];
    dst[(size_t)t * ldd + ch] = acc;
}

__global__ void __launch_bounds__(64) k_scan(float* P, const float* xbc, const float* wa, const float* ba, const float* wx, const float* bx, const float* lam) {
    __shared__ float Wr[HD][HD], Wi[HD][HD];
    __shared__ float xrow[2][HD];
    const int h = blockIdx.x, j = threadIdx.x, ch = h * HD + j;
    for (int dpass = 0; dpass < 2; ++dpass) {
        const int d = 1 - dpass;
        __syncthreads();
        for (int i = 0; i < HD; ++i) { Wr[i][j] = wa[(((size_t)d * NH + h) * HD + i) * HD + j]; Wi[i][j] = wx[(((size_t)d * NH + h) * HD + i) * HD + j]; }
        const float bar = ba[d * WL + ch], bxi = bx[d * WL + ch];
        const float l = lam[d * WL + ch];
        const float csp = -8.f * log1pf(expf(-l));
        float hst = 0.f;
        __syncthreads();
        for (int s = 0; s < CTX + SEQ; ++s) {
            const bool isctx = s < CTX;
            int t; float xv;
            if (isctx) { t = d ? (CTX - 1 - s) : s; xv = xbc[(size_t)t * WL + ch]; }
            else { const int s2 = s - CTX; t = d ? (SEQ - 1 - s2) : s2; xv = P[(size_t)t * NPROJ + WC + ch]; }
            xrow[s & 1][j] = xv;
            __syncthreads();
            float r = bar, ig = bxi;
#pragma unroll 8
            for (int i = 0; i < HD; ++i) { const float xi = xrow[s & 1][i]; r += xi * Wr[i][j]; ig += xi * Wi[i][j]; }
            r = sigmoidf_(r); ig = sigmoidf_(ig);
            const float log_a = csp * r;
            const float a = expf(log_a);
            const float bt = sqrtf(-expm1f(2.f * log_a)) * (ig * xv);
            hst = a * hst + bt;
            if (!isctx) {
                float* yp = P + (size_t)t * NPROJ + 2 * WC + ch;
                if (d == 1) *yp = hst;
                else *yp = (*yp + hst) * siluf_(P[(size_t)t * NPROJ + 5 * WC + ch]);
            }
        }
    }
}

__global__ void __launch_bounds__(256) k_final(float* out, const float* g) {
    __shared__ float red[256];
    float* r = out + (size_t)blockIdx.x * D;
    float s = 0.f;
    for (int i = threadIdx.x; i < D; i += 256) { const float v = r[i]; s += v * v; }
    red[threadIdx.x] = s; __syncthreads();
    for (int o = 128; o > 0; o >>= 1) { if (threadIdx.x < o) red[threadIdx.x] += red[threadIdx.x + o]; __syncthreads(); }
    const float rinv = rsqrtf(red[0] / D + EPS);
    for (int i = threadIdx.x; i < D; i += 256) r[i] = r[i] * rinv * g[i];
}

extern "C" void kernel_launch(void* const* d_in, const int* in_sizes, int n_in, void* d_out, int out_size, void* d_ws, size_t ws_size, hipStream_t stream) {
    const float* x = (const float*)d_in[0];      const float* c = (const float*)d_in[1];
    const float* ctx = (const float*)d_in[2];    const float* cctx = (const float*)d_in[3];
    const float* norm_g = (const float*)d_in[4]; const float* w_ada = (const float*)d_in[5];
    const float* b_ada = (const float*)d_in[6];  const float* w_in = (const float*)d_in[7];
    const float* wca = (const float*)d_in[8];    const float* wcb = (const float*)d_in[9];
    const float* bcb = (const float*)d_in[10];   const float* lwa = (const float*)d_in[11];
    const float* lba = (const float*)d_in[12];   const float* lwx = (const float*)d_in[13];
    const float* lbx = (const float*)d_in[14];   const float* llam = (const float*)d_in[15];
    const float* w_out = (const float*)d_in[16]; const float* final_g = (const float*)d_in[17];
    float* out = (float*)d_out;
    char* ws = (char*)d_ws;
    float* P = (float*)ws;
    size_t off = (size_t)SEQ * NPROJ * 4;
    float* mod = (float*)(ws + off); off += (size_t)2 * NPROJ * 4;
    float* HNC = (float*)(ws + off); off += (size_t)CTX * D * 4;
    float* VC = (float*)(ws + off);  off += (size_t)CTX * WL * 4;
    float* XBC = (float*)(ws + off); off += (size_t)CTX * WL * 4;
    if (off > ws_size) { fprintf(stderr, "workspace too small: need %zu have %zu\n", off, ws_size); return; }

    k_ada<<<NPROJ / 256, 256, 0, stream>>>(c, cctx, w_ada, b_ada, mod);
    k_normmod<<<SEQ, 256, 0, stream>>>(x, norm_g, mod, out);
    k_normmod<<<CTX, 256, 0, stream>>>(ctx, norm_g, mod + NPROJ, HNC);
    k_gemm<0><<<dim3(NPROJ / 64, SEQ / 64), 256, 0, stream>>>(out, D, w_in, NPROJ, P, NPROJ, D, nullptr, nullptr);
    k_gemm<0><<<dim3(WL / 64, CTX / 64), 256, 0, stream>>>(HNC, D, w_in + 4 * WC, NPROJ, VC, WL, D, nullptr, nullptr);
    k_mixA<<<SEQ * WC / 256, 256, 0, stream>>>(P, wca);
    k_convB<<<SEQ * WL / 256, 256, 0, stream>>>(P + 4 * WC, NPROJ, P + WC, NPROJ, wcb, bcb, GW);
    k_convB<<<CTX * WL / 256, 256, 0, stream>>>(VC, WL, XBC, WL, wcb, bcb, CTX);
    k_scan<<<NH, 64, 0, stream>>>(P, XBC, lwa, lba, lwx, lbx, llam);
    k_gemm<1><<<dim3(D / 64, SEQ / 64), 256, 0, stream>>>(P, NPROJ, w_out, D, out, D, D, x, mod + 2 * D);
    k_final<<<SEQ, 256, 0, stream>>>(out, final_g);
}
```
